# Optimizing an MI355X kernel written in HIP

```python
import math
import jax, jax.numpy as jnp
from jax import lax
import numpy as np

D_MODEL = 1024
BATCH = 8
SEQ = 2048
DEPTH = 1
DEC_BATCH = 32
DEC_SEQ = 4
PAST_LEN = 16384
PAGE_SIZE = 128

HG_HEADS = 4
HG_DK = 128
HG_DV = 128
HG_CHUNK = 64
MLA_HEADS = 4
QK_NOPE = 128
QK_ROPE = 64
V_DIM = 128
Q_LORA = 768
KV_LORA = 256
ROPE_THETA = 10000.0
Q_BLOCK = 128
D_FF = 2816
EPS = 1e-6

HG_KW = HG_HEADS * HG_DK
HG_WIDTH = HG_HEADS * HG_DV
MLA_WIDTH = MLA_HEADS * V_DIM
MIX_WIDTH = HG_WIDTH + MLA_WIDTH
IN_SIZES = (HG_KW, HG_KW, HG_WIDTH, HG_WIDTH, Q_LORA, KV_LORA, QK_ROPE)
IN_WIDTH = sum(IN_SIZES)
IN_OFFSETS = [int(v) for v in np.cumsum(IN_SIZES)[:-1]]
N_NORMS = 6

kernel_name = "hymba_hgrn2_mla_macaron_step"


def rmsnorm(x, g):
    xf = x.astype(jnp.float32)
    y = xf * lax.rsqrt(jnp.mean(xf * xf, axis=-1, keepdims=True) + EPS)
    return (y * g.astype(jnp.float32)).astype(x.dtype)


def rope(x, pos):
    half = x.shape[-1] // 2
    inv = ROPE_THETA ** (-jnp.arange(half, dtype=jnp.float32) / half)
    ang = pos.astype(jnp.float32)[:, None] * inv[None, :]
    cos = jnp.cos(ang)[:, None, :]
    sin = jnp.sin(ang)[:, None, :]
    xf = x.astype(jnp.float32)
    x1, x2 = xf[..., :half], xf[..., half:]
    out = jnp.concatenate([x1 * cos - x2 * sin, x1 * sin + x2 * cos], axis=-1)
    return out.astype(x.dtype)


def swiglu(x, wg, wu, wd):
    return (jax.nn.silu(x @ wg) * (x @ wu)) @ wd


def hgrn2_chunked(q, k, v, logf, s0):
    B, L, H, DK = q.shape
    DV = v.shape[-1]
    C = math.gcd(L, HG_CHUNK)
    n = L // C

    def chunks(a):
        return a.astype(jnp.float32).reshape(B, n, C, H, a.shape[-1]).transpose(1, 0, 3, 2, 4)

    tril = jnp.tril(jnp.ones((C, C), dtype=bool))

    def step(S, inp):
        qc, kc, vc, gc = inp
        b = jnp.cumsum(gc, axis=-2)
        diff = b[..., :, None, :] - b[..., None, :, :]
        decay = jnp.exp(jnp.where(tril[:, :, None], diff, -jnp.inf))
        A = jnp.einsum('bhtsk,bhsk->bhts', decay * qc[..., :, None, :], kc)
        o = jnp.einsum('bhts,bhsv->bhtv', A, vc) + jnp.einsum('bhtk,bhkv->bhtv', qc * jnp.exp(b), S)
        bl = b[..., -1:, :]
        S_new = jnp.exp(bl[..., 0, :])[..., None] * S + jnp.einsum('bhsk,bhsv->bhkv', kc * jnp.exp(bl - b), vc)
        return S_new, o

    S_fin, o = lax.scan(step, s0.astype(jnp.float32), (chunks(q), chunks(k), chunks(v), chunks(logf)))
    o = o.transpose(1, 0, 3, 2, 4).reshape(B, L, H, DV)
    return o.astype(v.dtype), S_fin.astype(s0.dtype)


def mla_attend(q_lat, q_rope, c_kv, k_rope, q_pos, k_pos):
    B, T = q_lat.shape[:2]
    blk = math.gcd(T, Q_BLOCK)
    nb = T // blk
    scale = 1.0 / math.sqrt(QK_NOPE + QK_ROPE)

    def blocks(a):
        return jnp.moveaxis(a.reshape(B, nb, blk, *a.shape[2:]), 1, 0)

    def one(args):
        ql, qr, qp = args
        s = (jnp.einsum('bqhr,bsr->bhqs', ql, c_kv) + jnp.einsum('bqhd,bsd->bhqs', qr, k_rope)).astype(jnp.float32) * scale
        s = jnp.where(k_pos[None, None, None, :] <= qp[None, None, :, None], s, -jnp.inf)
        p = jax.nn.softmax(s, axis=-1).astype(c_kv.dtype)
        return jnp.einsum('bhqs,bsr->bqhr', p, c_kv)

    out = lax.map(one, (blocks(q_lat), blocks(q_rope), q_pos.reshape(nb, blk)))
    return jnp.moveaxis(out, 0, 1).reshape(q_lat.shape)


def mixer(u, pos, past_ckv, past_kr, past_pos, s0, lb, w_in, q_norm_g, w_q_up, kv_norm_g, w_kv_up, hg_norm_g, w_out):
    B, T, _ = u.shape
    z = u @ w_in
    hq, hf, hi, hg, cq, ckv, kr = jnp.split(z, IN_OFFSETS, axis=-1)
    f = lb + (1.0 - lb) * jax.nn.sigmoid(hf.astype(jnp.float32))
    logf = jnp.log(f)
    k = 1.0 - f
    q = jax.nn.silu(hq)
    heads = lambda a, d: a.reshape(B, T, HG_HEADS, d)
    o_h, s_fin = hgrn2_chunked(heads(q, HG_DK), heads(k, HG_DK), heads(hi, HG_DV), heads(logf, HG_DK), s0)
    o_h = rmsnorm(o_h, hg_norm_g) * jax.nn.silu(heads(hg, HG_DV))
    cq = rmsnorm(cq, q_norm_g)
    qh = jnp.einsum('btc,chd->bthd', cq, w_q_up)
    q_nope = qh[..., :QK_NOPE]
    q_r = rope(qh[..., QK_NOPE:], pos)
    c_kv = rmsnorm(ckv, kv_norm_g)
    k_r = rope(kr[:, :, None, :], pos)[:, :, 0, :]
    w_uk = w_kv_up[..., :QK_NOPE]
    w_uv = w_kv_up[..., QK_NOPE:]
    q_lat = jnp.einsum('bthd,rhd->bthr', q_nope, w_uk)
    keys_c = jnp.concatenate([past_ckv, c_kv], axis=1)
    keys_r = jnp.concatenate([past_kr, k_r], axis=1)
    k_pos = jnp.concatenate([past_pos, pos])
    o_lat = mla_attend(q_lat, q_r, keys_c, keys_r, pos, k_pos)
    o_m = jnp.einsum('bthr,rhv->bthv', o_lat, w_uv)
    o = jnp.concatenate([o_h.reshape(B, T, HG_WIDTH), o_m.reshape(B, T, MLA_WIDTH)], axis=-1)
    return o @ w_out, c_kv, k_r, s_fin


def layer(h, pos, past_ckv, past_kr, past_pos, s0, lb, norm_g, wg, wu, wd,
          w_in, q_norm_g, w_q_up, kv_norm_g, w_kv_up, hg_norm_g, w_out):
    h = h + 0.5 * rmsnorm(swiglu(rmsnorm(h, norm_g[0]), wg[0], wu[0], wd[0]), norm_g[1])
    m, c_kv, k_r, s_fin = mixer(rmsnorm(h, norm_g[2]), pos, past_ckv, past_kr, past_pos, s0, lb,
                                w_in, q_norm_g, w_q_up, kv_norm_g, w_kv_up, hg_norm_g, w_out)
    h = h + rmsnorm(m, norm_g[3])
    h = h + 0.5 * rmsnorm(swiglu(rmsnorm(h, norm_g[4]), wg[1], wu[1], wd[1]), norm_g[5])
    return h, c_kv, k_r, s_fin


def setup_inputs(seed: int = 0) -> dict:
    key = jax.random.key(seed)
    ks = jax.random.split(key, 20)
    n_pages = PAST_LEN // PAGE_SIZE
    n_used = DEC_BATCH * n_pages
    n_pool = (5 * n_used) // 4
    nrm = lambda k, shape, s: jax.random.normal(k, shape, dtype=jnp.float32) * s
    page_table = jax.random.permutation(ks[5], n_pool)[:n_used].reshape(DEC_BATCH, n_pages).astype(jnp.int32)
    return {
        "x_prompt": nrm(ks[0], (BATCH, SEQ, D_MODEL), 1.0),
        "x_sample": nrm(ks[1], (DEC_BATCH, DEC_SEQ, D_MODEL), 1.0),
        "cache_kv_latent": nrm(ks[2], (DEPTH, n_pool, PAGE_SIZE, KV_LORA), 1.0),
        "cache_k_rope": nrm(ks[3], (DEPTH, n_pool, PAGE_SIZE, QK_ROPE), 1.0),
        "state_hgrn": nrm(ks[4], (DEPTH, DEC_BATCH, HG_HEADS, HG_DK, HG_DV), 0.5),
        "page_table": page_table,
        "hgrn_lb_logits": nrm(ks[6], (DEPTH + 1, HG_KW), 0.5),
        "norm_g": 1.0 + nrm(ks[7], (DEPTH, N_NORMS, D_MODEL), 0.1),
        "w_ffn_gate": nrm(ks[8], (DEPTH, 2, D_MODEL, D_FF), D_MODEL ** -0.5),
        "w_ffn_up": nrm(ks[9], (DEPTH, 2, D_MODEL, D_FF), D_MODEL ** -0.5),
        "w_ffn_down": nrm(ks[10], (DEPTH, 2, D_FF, D_MODEL), D_FF ** -0.5),
        "w_in": nrm(ks[11], (DEPTH, D_MODEL, IN_WIDTH), D_MODEL ** -0.5),
        "q_norm_g": 1.0 + nrm(ks[12], (DEPTH, Q_LORA), 0.1),
        "w_q_up": nrm(ks[13], (DEPTH, Q_LORA, MLA_HEADS, QK_NOPE + QK_ROPE), Q_LORA ** -0.5),
        "kv_norm_g": 1.0 + nrm(ks[14], (DEPTH, KV_LORA), 0.1),
        "w_kv_up": nrm(ks[15], (DEPTH, KV_LORA, MLA_HEADS, QK_NOPE + V_DIM), KV_LORA ** -0.5),
        "hg_norm_g": 1.0 + nrm(ks[16], (DEPTH, HG_DV), 0.1),
        "w_out": nrm(ks[17], (DEPTH, MIX_WIDTH, D_MODEL), MIX_WIDTH ** -0.5),
    }


def reference(x_prompt, x_sample, cache_kv_latent, cache_k_rope, state_hgrn, page_table,
              hgrn_lb_logits, norm_g, w_ffn_gate, w_ffn_up, w_ffn_down, w_in, q_norm_g, w_q_up,
              kv_norm_g, w_kv_up, hg_norm_g, w_out):
    Bp, Tp, _ = x_prompt.shape
    Bs, Ts, _ = x_sample.shape
    past_len = page_table.shape[1] * cache_kv_latent.shape[2]
    pos_p = jnp.arange(Tp, dtype=jnp.int32)
    pos_s = past_len + jnp.arange(Ts, dtype=jnp.int32)
    past_pos_s = jnp.arange(past_len, dtype=jnp.int32)
    empty_pos = jnp.zeros((0,), dtype=jnp.int32)
    lb_all = jnp.cumsum(jax.nn.softmax(hgrn_lb_logits.astype(jnp.float32), axis=0), axis=0)

    hp, hs = x_prompt, x_sample
    ckv_p, kr_p, st_p, ckv_s, kr_s, st_s = [], [], [], [], [], []
    for l in range(DEPTH):
        w = (lb_all[l], norm_g[l], w_ffn_gate[l], w_ffn_up[l], w_ffn_down[l], w_in[l], q_norm_g[l],
             w_q_up[l], kv_norm_g[l], w_kv_up[l], hg_norm_g[l], w_out[l])
        hp, c1, r1, s1 = layer(hp, pos_p,
                               jnp.zeros((Bp, 0, KV_LORA), hp.dtype), jnp.zeros((Bp, 0, QK_ROPE), hp.dtype),
                               empty_pos, jnp.zeros((Bp, HG_HEADS, HG_DK, HG_DV), hp.dtype), *w)
        past_c = cache_kv_latent[l][page_table].reshape(Bs, past_len, KV_LORA)
        past_r = cache_k_rope[l][page_table].reshape(Bs, past_len, QK_ROPE)
        hs, c2, r2, s2 = layer(hs, pos_s, past_c, past_r, past_pos_s, state_hgrn[l], *w)
        ckv_p.append(c1); kr_p.append(r1); st_p.append(s1)
        ckv_s.append(c2); kr_s.append(r2); st_s.append(s2)

    return (hp, hs, jnp.stack(ckv_p), jnp.stack(kr_p), jnp.stack(st_p),
            jnp.stack(ckv_s), jnp.stack(kr_s), jnp.stack(st_s))
```

```cpp
#include <hip/hip_runtime.h>
#include <cstdint>
#include <cstdio>

constexpr int D = 1024, BATCH = 8, SEQ = 2048, DECB = 32, DECT = 4, PAST = 16384, PAGE = 128, NPAGES = PAST / PAGE;
constexpr int HGH = 4, DK = 128, DV = 128, MLAH = 4, NOPE = 128, ROPE = 64, VD = 128, QL = 768, KVL = 256, DFF = 2816;
constexpr int MP = BATCH * SEQ, MS = DECB * DECT, M = MP + MS;
constexpr int INW = 3136;
constexpr int O_Q = 0, O_F = 512, O_I = 1024, O_G = 1536, O_CQ = 2048, O_CKV = 2816, O_KR = 3072;
constexpr float EPS = 1e-6f;
constexpr int QKD = KVL + ROPE;

constexpr size_t OUT_Y = 0;
constexpr size_t OUT_CKV_P = (size_t)M * D;
constexpr size_t OUT_KR_P = OUT_CKV_P + (size_t)MP * KVL;
constexpr size_t OUT_ST_P = OUT_KR_P + (size_t)MP * ROPE;
constexpr size_t OUT_CKV_S = OUT_ST_P + (size_t)BATCH * HGH * DK * DV;
constexpr size_t OUT_KR_S = OUT_CKV_S + (size_t)MS * KVL;
constexpr size_t OUT_ST_S = OUT_KR_S + (size_t)MS * ROPE;
constexpr size_t OUT_END = OUT_ST_S + (size_t)DECB * HGH * DK * DV;

__device__ __forceinline__ float wave_sum(float v) {
#pragma unroll
    for (int o = 1; o < 64; o <<= 1) v += __shfl_xor(v, o);
    return v;
}
__device__ __forceinline__ float siluf(float x) { return x / (1.f + __expf(-x)); }
__device__ __forceinline__ float sigmf(float x) { return 1.f / (1.f + __expf(-x)); }

__global__ void __launch_bounds__(256) gemm_f32(const float* __restrict__ A, int lda, long sAz, const float* __restrict__ B, int sbk, int sbn, long sBz,
                                                float* __restrict__ C, int ldc, long sCz, int K) {
    __shared__ float As[16][65], Bs[16][65];
    const int tid = threadIdx.x, tx = tid & 15, ty = tid >> 4;
    const int m0 = blockIdx.y * 64, n0 = blockIdx.x * 64;
    A += (long)blockIdx.z * sAz; B += (long)blockIdx.z * sBz; C += (long)blockIdx.z * sCz;
    float acc[4][4] = {};
    for (int k0 = 0; k0 < K; k0 += 16) {
#pragma unroll
        for (int i = 0; i < 4; ++i) { const int e = tid + i * 256, r = e >> 4, kk = e & 15; As[kk][r] = A[(long)(m0 + r) * lda + k0 + kk]; }
        if (sbn == 1) {
#pragma unroll
            for (int i = 0; i < 4; ++i) { const int e = tid + i * 256, kk = e >> 6, c = e & 63; Bs[kk][c] = B[(long)(k0 + kk) * sbk + n0 + c]; }
        } else {
#pragma unroll
            for (int i = 0; i < 4; ++i) { const int e = tid + i * 256, c = e >> 4, kk = e & 15; Bs[kk][c] = B[(long)(k0 + kk) * sbk + (long)(n0 + c) * sbn]; }
        }
        __syncthreads();
#pragma unroll
        for (int kk = 0; kk < 16; ++kk) {
            float a[4], b[4];
#pragma unroll
            for (int i = 0; i < 4; ++i) { a[i] = As[kk][ty * 4 + i]; b[i] = Bs[kk][tx * 4 + i]; }
#pragma unroll
            for (int i = 0; i < 4; ++i)
#pragma unroll
                for (int j = 0; j < 4; ++j) acc[i][j] += a[i] * b[j];
        }
        __syncthreads();
    }
#pragma unroll
    for (int i = 0; i < 4; ++i)
#pragma unroll
        for (int j = 0; j < 4; ++j) C[(long)(m0 + ty * 4 + i) * ldc + n0 + tx * 4 + j] = acc[i][j];
}

__global__ void __launch_bounds__(256) rmsnorm_rows(const float* __restrict__ in, int ldi, const float* __restrict__ g, float* __restrict__ out, int ldo, int rows, int ncols) {
    const int row = blockIdx.x * 4 + (threadIdx.x >> 6), lane = threadIdx.x & 63;
    if (row >= rows) return;
    const float* x = in + (long)row * ldi; float s = 0.f;
    for (int c = lane; c < ncols; c += 64) { const float v = x[c]; s += v * v; }
    s = wave_sum(s);
    const float r = rsqrtf(s / (float)ncols + EPS);
    for (int c = lane; c < ncols; c += 64) out[(long)row * ldo + c] = x[c] * r * g[c];
}
__global__ void __launch_bounds__(256) resid_norm_rows(const float* __restrict__ base, const float* __restrict__ m, const float* __restrict__ g, float scale, float* __restrict__ out, int rows) {
    const int row = blockIdx.x * 4 + (threadIdx.x >> 6), lane = threadIdx.x & 63;
    if (row >= rows) return;
    const float* x = m + (long)row * D; float s = 0.f;
    for (int c = lane; c < D; c += 64) { const float v = x[c]; s += v * v; }
    s = wave_sum(s);
    const float r = rsqrtf(s / (float)D + EPS);
    for (int c = lane; c < D; c += 64) out[(long)row * D + c] = base[(long)row * D + c] + scale * x[c] * r * g[c];
}
__global__ void swiglu_elem(const float* __restrict__ G, const float* __restrict__ U, float* __restrict__ act, long n) {
    const long i = (long)blockIdx.x * blockDim.x + threadIdx.x;
    if (i < n) act[i] = siluf(G[i]) * U[i];
}

__device__ __forceinline__ void rope_cs(int pos, int i, float& c, float& s) {
    const float inv = exp2f(-(float)i * (13.287712379549449f / 32.f));
    const float ang = (float)pos * inv;
    const double a = (double)ang; const double k = rint(a * 0.15915494309189535); const float r = (float)(a - k * 6.283185307179586);
    c = cosf(r); s = sinf(r);
}
__device__ __forceinline__ int row_pos(int row) { return row < MP ? (row % SEQ) : (PAST + ((row - MP) % DECT)); }

__global__ void __launch_bounds__(256) mixer_split(const float* __restrict__ z, const float* __restrict__ lb_logits, const float* __restrict__ q_norm_g, const float* __restrict__ kv_norm_g,
                                                   float* __restrict__ hq, float* __restrict__ lgf, float* __restrict__ hk, float* __restrict__ hv, float* __restrict__ hgate,
                                                   float* __restrict__ cqn, float* __restrict__ kcat  , float* __restrict__ out) {
    const int row = blockIdx.x * 4 + (threadIdx.x >> 6), lane = threadIdx.x & 63;
    if (row >= M) return;
    const float* zr = z + (long)row * INW;
    for (int c = lane; c < 512; c += 64) {
        const float lb = sigmf(lb_logits[c] - lb_logits[512 + c]);
        const float f = lb + (1.f - lb) * sigmf(zr[O_F + c]);
        hq[(long)row * 512 + c] = siluf(zr[O_Q + c]);
        lgf[(long)row * 512 + c] = logf(f);
        hk[(long)row * 512 + c] = 1.f - f;
        hv[(long)row * 512 + c] = zr[O_I + c];
        hgate[(long)row * 512 + c] = siluf(zr[O_G + c]);
    }
    { float s = 0.f; for (int c = lane; c < QL; c += 64) { const float v = zr[O_CQ + c]; s += v * v; } s = wave_sum(s); const float r = rsqrtf(s / (float)QL + EPS);
      for (int c = lane; c < QL; c += 64) cqn[(long)row * QL + c] = zr[O_CQ + c] * r * q_norm_g[c]; }
    float* ockv = row < MP ? out + OUT_CKV_P + (long)row * KVL : out + OUT_CKV_S + (long)(row - MP) * KVL;
    float* okr = row < MP ? out + OUT_KR_P + (long)row * ROPE : out + OUT_KR_S + (long)(row - MP) * ROPE;
    { float s = 0.f; for (int c = lane; c < KVL; c += 64) { const float v = zr[O_CKV + c]; s += v * v; } s = wave_sum(s); const float r = rsqrtf(s / (float)KVL + EPS);
      for (int c = lane; c < KVL; c += 64) { const float v = zr[O_CKV + c] * r * kv_norm_g[c]; ockv[c] = v; kcat[(long)row * QKD + c] = v; } }
    if (lane < 32) { float c, s; rope_cs(row_pos(row), lane, c, s); const float x1 = zr[O_KR + lane], x2 = zr[O_KR + 32 + lane];
        const float o1 = x1 * c - x2 * s, o2 = x1 * s + x2 * c; okr[lane] = o1; okr[32 + lane] = o2; kcat[(long)row * QKD + KVL + lane] = o1; kcat[(long)row * QKD + KVL + 32 + lane] = o2; }
}

__global__ void __launch_bounds__(256) q_absorb(const float* __restrict__ qh, const float* __restrict__ w_kv_up, float* __restrict__ qcat) {
    const int row = blockIdx.x, h = blockIdx.y, tid = threadIdx.x;
    __shared__ float qn[128];
    const float* q = qh + ((long)row * 4 + h) * 192;
    if (tid < 128) qn[tid] = q[tid];
    __syncthreads();
    { const int r = tid; const float* w = w_kv_up + ((long)r * 4 + h) * 256; float s = 0.f;
      for (int d = 0; d < 128; ++d) s += qn[d] * w[d];
      qcat[((long)row * 4 + h) * QKD + r] = s; }
    if (tid < 32) { float c, s; rope_cs(row_pos(row), tid, c, s); const float x1 = q[128 + tid], x2 = q[160 + tid];
        qcat[((long)row * 4 + h) * QKD + KVL + tid] = x1 * c - x2 * s; qcat[((long)row * 4 + h) * QKD + KVL + 32 + tid] = x1 * s + x2 * c; }
}

__global__ void __launch_bounds__(256) softmax_prompt(float* __restrict__ S, float scale) {
    const long rowi = (long)blockIdx.x * 4 + (threadIdx.x >> 6); const int lane = threadIdx.x & 63;
    const int t = (int)((rowi % (SEQ * 4)) / 4);
    float* s = S + rowi * SEQ;
    float mx = -INFINITY;
    for (int k = lane; k <= t; k += 64) mx = fmaxf(mx, s[k] * scale);
#pragma unroll
    for (int o = 1; o < 64; o <<= 1) mx = fmaxf(mx, __shfl_xor(mx, o));
    float sum = 0.f;
    for (int k = lane; k <= t; k += 64) sum += __expf(s[k] * scale - mx);
    sum = wave_sum(sum);
    const float inv = 1.f / sum;
    for (int k = lane; k < SEQ; k += 64) s[k] = (k <= t) ? __expf(s[k] * scale - mx) * inv : 0.f;
}

constexpr int KS = PAST + DECT;
__global__ void __launch_bounds__(256) sample_scores(const float* __restrict__ qcat  , const float* __restrict__ cache_c, const float* __restrict__ cache_r,
                                                     const int* __restrict__ page_table, const float* __restrict__ kcat, float* __restrict__ SS, float scale) {
    const int b = blockIdx.y, lane = threadIdx.x & 63, w = threadIdx.x >> 6;
    __shared__ float q[16][QKD];
    for (int i = threadIdx.x; i < 16 * QKD; i += 256) q[i / QKD][i % QKD] = qcat[((long)(MP + b * DECT) * 4) * QKD + i];
    __syncthreads();
    for (int key = blockIdx.x * 4 + w; key < KS; key += gridDim.x * 4) {
        float kc[4], kr;
        if (key < PAST) { const int pg = page_table[b * NPAGES + key / PAGE]; const float* c = cache_c + ((long)pg * PAGE + key % PAGE) * KVL; const float* r = cache_r + ((long)pg * PAGE + key % PAGE) * ROPE;
#pragma unroll
            for (int j = 0; j < 4; ++j) kc[j] = c[lane + 64 * j]; kr = r[lane]; }
        else { const float* c = kcat + (long)(MP + b * DECT + key - PAST) * QKD;
#pragma unroll
            for (int j = 0; j < 4; ++j) kc[j] = c[lane + 64 * j]; kr = c[KVL + lane]; }
        for (int r = 0; r < 16; ++r) {
            float s = kr * q[r][KVL + lane];
#pragma unroll
            for (int j = 0; j < 4; ++j) s += kc[j] * q[r][lane + 64 * j];
            s = wave_sum(s);
            if (lane == 0) { const int t = r >> 2; const bool ok = key < PAST || (key - PAST) <= t; SS[((long)b * 16 + r) * KS + key] = ok ? s * scale : -INFINITY; }
        }
    }
}
__global__ void __launch_bounds__(256) softmax_sample(float* __restrict__ SS) {
    float* s = SS + (long)blockIdx.x * KS; const int tid = threadIdx.x, lane = tid & 63, w = tid >> 6;
    __shared__ float red[4];
    float mx = -INFINITY; for (int k = tid; k < KS; k += 256) mx = fmaxf(mx, s[k]);
#pragma unroll
    for (int o = 1; o < 64; o <<= 1) mx = fmaxf(mx, __shfl_xor(mx, o));
    if (lane == 0) red[w] = mx; __syncthreads(); mx = fmaxf(fmaxf(red[0], red[1]), fmaxf(red[2], red[3])); __syncthreads();
    float sum = 0.f; for (int k = tid; k < KS; k += 256) sum += __expf(s[k] - mx);
    sum = wave_sum(sum); if (lane == 0) red[w] = sum; __syncthreads(); sum = red[0] + red[1] + red[2] + red[3];
    const float inv = 1.f / sum;
    for (int k = tid; k < KS; k += 256) s[k] = __expf(s[k] - mx) * inv;
}
constexpr int NCH = NPAGES + 1;
__global__ void __launch_bounds__(256) sample_pv(const float* __restrict__ SS, const float* __restrict__ cache_c, const int* __restrict__ page_table, const float* __restrict__ kcat, float* __restrict__ part) {
    const int ch = blockIdx.x, b = blockIdx.y, tid = threadIdx.x;
    float acc[16] = {};
    const int k0 = ch * PAGE, k1 = ch < NPAGES ? k0 + PAGE : KS;
    __shared__ float p[16][PAGE];
    for (int i = tid; i < 16 * PAGE; i += 256) { const int r = i / PAGE, k = i % PAGE; p[r][k] = (k0 + k < k1) ? SS[((long)b * 16 + r) * KS + k0 + k] : 0.f; }
    __syncthreads();
    for (int key = k0; key < k1; ++key) {
        float v;
        if (key < PAST) { const int pg = page_table[b * NPAGES + key / PAGE]; v = cache_c[((long)pg * PAGE + key % PAGE) * KVL + tid]; }
        else v = kcat[(long)(MP + b * DECT + key - PAST) * QKD + tid];
#pragma unroll
        for (int r = 0; r < 16; ++r) acc[r] += p[r][key - k0] * v;
    }
#pragma unroll
    for (int r = 0; r < 16; ++r) part[(((long)b * NCH + ch) * 16 + r) * KVL + tid] = acc[r];
}
__global__ void __launch_bounds__(256) sample_pv_reduce(const float* __restrict__ part, float* __restrict__ olat  ) {
    const int b = blockIdx.y, r = blockIdx.x, tid = threadIdx.x; float s = 0.f;
    for (int ch = 0; ch < NCH; ++ch) s += part[(((long)b * NCH + ch) * 16 + r) * KVL + tid];
    olat[((long)(MP + b * DECT) * 4 + r) * KVL + tid] = s;
}

__global__ void __launch_bounds__(256) hgrn_seq(const float* __restrict__ hq, const float* __restrict__ lgf, const float* __restrict__ hk, const float* __restrict__ hv, const float* __restrict__ s0  ,
                                                float* __restrict__ oh  , float* __restrict__ sfin, int row0, int T) {
    const int vs = blockIdx.x, h = blockIdx.y, b = blockIdx.z, tid = threadIdx.x, kg = tid & 15, vi = tid >> 4, v = vs * 16 + vi;
    float S[8];
#pragma unroll
    for (int j = 0; j < 8; ++j) S[j] = s0 ? s0[(((long)b * HGH + h) * DK + kg * 8 + j) * DV + v] : 0.f;
    for (int t = 0; t < T; ++t) {
        const long row = row0 + (long)b * T + t; const long base = row * 512 + h * 128;
        const float vv = hv[base + v]; float o = 0.f;
#pragma unroll
        for (int j = 0; j < 8; ++j) { const int k = kg * 8 + j; const float f = __expf(lgf[base + k]); S[j] = f * S[j] + hk[base + k] * vv; o += S[j] * hq[base + k]; }
        o += __shfl_xor(o, 1); o += __shfl_xor(o, 2); o += __shfl_xor(o, 4); o += __shfl_xor(o, 8);
        if (kg == 0) oh[base + v] = o;
    }
#pragma unroll
    for (int j = 0; j < 8; ++j) sfin[(((long)b * HGH + h) * DK + kg * 8 + j) * DV + v] = S[j];
}
__global__ void __launch_bounds__(256) hgrn_out(const float* __restrict__ oh, const float* __restrict__ gate, const float* __restrict__ g, float* __restrict__ ocat) {
    const long idx = (long)blockIdx.x * 4 + (threadIdx.x >> 6); const int lane = threadIdx.x & 63;
    if (idx >= (long)M * 4) return;
    const long row = idx >> 2; const int h = (int)(idx & 3);
    const float* o = oh + row * 512 + h * 128; const float a = o[lane], b = o[lane + 64];
    const float s = wave_sum(a * a + b * b); const float r = rsqrtf(s / 128.f + EPS);
    ocat[row * D + h * 128 + lane] = a * r * g[lane] * gate[row * 512 + h * 128 + lane];
    ocat[row * D + h * 128 + lane + 64] = b * r * g[lane + 64] * gate[row * 512 + h * 128 + lane + 64];
}
__global__ void __launch_bounds__(128) o_up(const float* __restrict__ olat, const float* __restrict__ w_kv_up, float* __restrict__ ocat) {
    const int row = blockIdx.x, h = blockIdx.y, v = threadIdx.x;
    __shared__ float ol[256];
    ol[v] = olat[((long)row * 4 + h) * KVL + v]; ol[v + 128] = olat[((long)row * 4 + h) * KVL + v + 128];
    __syncthreads();
    float s = 0.f;
    for (int r = 0; r < 256; ++r) s += ol[r] * w_kv_up[((long)r * 4 + h) * 256 + 128 + v];
    ocat[(long)row * D + 512 + h * 128 + v] = s;
}

static void gemm(hipStream_t st, const float* A, int lda, long sAz, const float* B, int sbk, int sbn, long sBz, float* C, int ldc, long sCz, int m, int n, int k, int batch) {
    hipLaunchKernelGGL(gemm_f32, dim3(n / 64, m / 64, batch), dim3(256), 0, st, A, lda, sAz, B, sbk, sbn, sBz, C, ldc, sCz, k);
}

extern "C" void kernel_launch(void* const* d_in, const int* in_sizes, int n_in, void* d_out, int out_size, void* d_ws, size_t ws_size, hipStream_t stream) {
    const float* x_prompt = (const float*)d_in[0]; const float* x_sample = (const float*)d_in[1];
    const float* cache_c = (const float*)d_in[2]; const float* cache_r = (const float*)d_in[3]; const float* state = (const float*)d_in[4];
    const int* page_table = (const int*)d_in[5]; const float* lb_logits = (const float*)d_in[6]; const float* norm_g = (const float*)d_in[7];
    const float* wg = (const float*)d_in[8]; const float* wu = (const float*)d_in[9]; const float* wd = (const float*)d_in[10]; const float* w_in = (const float*)d_in[11];
    const float* q_norm_g = (const float*)d_in[12]; const float* w_q_up = (const float*)d_in[13]; const float* kv_norm_g = (const float*)d_in[14]; const float* w_kv_up = (const float*)d_in[15];
    const float* hg_norm_g = (const float*)d_in[16]; const float* w_out = (const float*)d_in[17];
    float* out = (float*)d_out;
    float* ws = (float*)d_ws; size_t off = 0;
    auto alloc = [&](size_t n) { float* p = ws + off; off += (n + 63) & ~(size_t)63; return p; };
    float* X = alloc((size_t)M * D);
    float* XN = alloc((size_t)M * D);
    float* BIG = alloc((size_t)3 * M * DFF); float* G = BIG; float* U = BIG + (size_t)M * DFF; float* ACT = G;
    float* MM = alloc((size_t)M * D); float* H1 = alloc((size_t)M * D); float* H2 = alloc((size_t)M * D);
    float* Z = alloc((size_t)M * INW);
    float* HQ = alloc((size_t)M * 512); float* LOGF = alloc((size_t)M * 512); float* HK = alloc((size_t)M * 512); float* HV = alloc((size_t)M * 512); float* HGATE = alloc((size_t)M * 512);
    float* OH = alloc((size_t)M * 512);
    float* CQN = alloc((size_t)M * QL); float* KCAT = alloc((size_t)M * QKD); float* QH = alloc((size_t)M * 768); float* QCAT = alloc((size_t)M * 4 * QKD);
    float* SP = BIG; static_assert((size_t)BATCH * SEQ * 4 * SEQ <= (size_t)3 * M * DFF, "SP fits");
    float* OLAT = alloc((size_t)M * 4 * KVL);
    float* SS = alloc((size_t)DECB * 16 * KS); float* PART = alloc((size_t)DECB * NCH * 16 * KVL);
    float* OCAT = alloc((size_t)M * D);
    if (off * 4 > ws_size) { fprintf(stderr, "ws too small: need %zu have %zu\n", off * 4, ws_size); return; }

    hipMemcpyAsync(X, x_prompt, (size_t)MP * D * 4, hipMemcpyDeviceToDevice, stream);
    hipMemcpyAsync(X + (size_t)MP * D, x_sample, (size_t)MS * D * 4, hipMemcpyDeviceToDevice, stream);
    const float scale = 1.0f / sqrtf(192.f);
    hipLaunchKernelGGL(rmsnorm_rows, dim3(M / 4), dim3(256), 0, stream, X, D, norm_g + 0 * D, XN, D, M, D);
    gemm(stream, XN, D, 0, wg, DFF, 1, 0, G, DFF, 0, M, DFF, D, 1);
    gemm(stream, XN, D, 0, wu, DFF, 1, 0, U, DFF, 0, M, DFF, D, 1);
    hipLaunchKernelGGL(swiglu_elem, dim3((unsigned)(((size_t)M * DFF + 255) / 256)), dim3(256), 0, stream, G, U, ACT, (long)M * DFF);
    gemm(stream, ACT, DFF, 0, wd, D, 1, 0, MM, D, 0, M, D, DFF, 1);
    hipLaunchKernelGGL(resid_norm_rows, dim3(M / 4), dim3(256), 0, stream, X, MM, norm_g + 1 * D, 0.5f, H1, M);
    hipLaunchKernelGGL(rmsnorm_rows, dim3(M / 4), dim3(256), 0, stream, H1, D, norm_g + 2 * D, XN, D, M, D);
    gemm(stream, XN, D, 0, w_in, INW, 1, 0, Z, INW, 0, M, INW, D, 1);
    hipLaunchKernelGGL(mixer_split, dim3(M / 4), dim3(256), 0, stream, Z, lb_logits, q_norm_g, kv_norm_g, HQ, LOGF, HK, HV, HGATE, CQN, KCAT, out);
    gemm(stream, CQN, QL, 0, w_q_up, 768, 1, 0, QH, 768, 0, M, 768, QL, 1);
    hipLaunchKernelGGL(q_absorb, dim3(M, 4), dim3(256), 0, stream, QH, w_kv_up, QCAT);
    gemm(stream, QCAT, QKD, (long)SEQ * 4 * QKD, KCAT, 1, QKD, (long)SEQ * QKD, SP, SEQ, (long)SEQ * 4 * SEQ, SEQ * 4, SEQ, QKD, BATCH);
    hipLaunchKernelGGL(softmax_prompt, dim3(BATCH * SEQ * 4 / 4), dim3(256), 0, stream, SP, scale);
    gemm(stream, SP, SEQ, (long)SEQ * 4 * SEQ, KCAT, QKD, 1, (long)SEQ * QKD, OLAT, KVL, (long)SEQ * 4 * KVL, SEQ * 4, KVL, SEQ, BATCH);
    hipLaunchKernelGGL(sample_scores, dim3(64, DECB), dim3(256), 0, stream, QCAT, cache_c, cache_r, page_table, KCAT, SS, scale);
    hipLaunchKernelGGL(softmax_sample, dim3(DECB * 16), dim3(256), 0, stream, SS);
    hipLaunchKernelGGL(sample_pv, dim3(NCH, DECB), dim3(256), 0, stream, SS, cache_c, page_table, KCAT, PART);
    hipLaunchKernelGGL(sample_pv_reduce, dim3(16, DECB), dim3(256), 0, stream, PART, OLAT);
    hipLaunchKernelGGL(o_up, dim3(M, 4), dim3(128), 0, stream, OLAT, w_kv_up, OCAT);
    hipLaunchKernelGGL(hgrn_seq, dim3(8, HGH, BATCH), dim3(256), 0, stream, HQ, LOGF, HK, HV, (const float*)nullptr, OH, out + OUT_ST_P, 0, SEQ);
    hipLaunchKernelGGL(hgrn_seq, dim3(8, HGH, DECB), dim3(256), 0, stream, HQ, LOGF, HK, HV, state, OH, out + OUT_ST_S, MP, DECT);
    hipLaunchKernelGGL(hgrn_out, dim3(M), dim3(256), 0, stream, OH, HGATE, hg_norm_g, OCAT);
    gemm(stream, OCAT, D, 0, w_out, D, 1, 0, MM, D, 0, M, D, D, 1);
    hipLaunchKernelGGL(resid_norm_rows, dim3(M / 4), dim3(256), 0, stream, H1, MM, norm_g + 3 * D, 1.0f, H2, M);
    hipLaunchKernelGGL(rmsnorm_rows, dim3(M / 4), dim3(256), 0, stream, H2, D, norm_g + 4 * D, XN, D, M, D);
    gemm(stream, XN, D, 0, wg + (size_t)D * DFF, DFF, 1, 0, G, DFF, 0, M, DFF, D, 1);
    gemm(stream, XN, D, 0, wu + (size_t)D * DFF, DFF, 1, 0, U, DFF, 0, M, DFF, D, 1);
    hipLaunchKernelGGL(swiglu_elem, dim3((unsigned)(((size_t)M * DFF + 255) / 256)), dim3(256), 0, stream, G, U, ACT, (long)M * DFF);
    gemm(stream, ACT, DFF, 0, wd + (size_t)DFF * D, D, 1, 0, MM, D, 0, M, D, DFF, 1);
    hipLaunchKernelGGL(resid_norm_rows, dim3(M / 4), dim3(256), 0, stream, H2, MM, norm_g + 5 * D, 0.5f, out + OUT_Y, M);
}
```
